# Optimizing an MI355X kernel written in HIP

```python
import jax, jax.numpy as jnp
from jax import lax
import numpy as np

D_MODEL = 1024
BATCH = 2
SEQ = 16384
DEPTH = 1
DEC_BATCH = 16
DEC_SEQ = 2048
PAST_LEN = 128

CHUNK = 128
E_A = D_MODEL
A_GROUPS = 8
A_GROUP_W = E_A // A_GROUPS
E_B = D_MODEL
POOL_WINDOWS = (2, 4, 8, 16)
POOL_GROUPS = len(POOL_WINDOWS)
POOL_GROUP_W = E_B // POOL_GROUPS
IN_WIDTHS = (E_A, E_A, E_A, E_B, E_B, D_MODEL, D_MODEL)
IN_TOTAL = sum(IN_WIDTHS)
SPLIT_POINTS = [int(s) for s in np.cumsum(IN_WIDTHS)[:-1]]
DEEPNORM_ALPHA = (2.0 * DEPTH) ** 0.25
DEEPNORM_BETA = (8.0 * DEPTH) ** -0.25
LN_EPS = 1e-5

kernel_name = "gated_spatial_pool_hybrid_encoder"


def _layernorm(x, g, b):
    xf = x.astype(jnp.float32)
    mu = jnp.mean(xf, axis=-1, keepdims=True)
    xc = xf - mu
    var = jnp.mean(xc * xc, axis=-1, keepdims=True)
    return (xc * lax.rsqrt(var + LN_EPS) * g.astype(jnp.float32) + b.astype(jnp.float32)).astype(x.dtype)


def _centred_pool_minus_self(p, window):
    b, s, c = p.shape
    pf = p.astype(jnp.float32)
    csum = jnp.concatenate([jnp.zeros((b, 1, c), jnp.float32), jnp.cumsum(pf, axis=1)], axis=1)
    t = jnp.arange(s)
    lo = jnp.clip(t - window // 2, 0, s)
    hi = jnp.clip(t + window - window // 2, 0, s)
    sums = jnp.take(csum, hi, axis=1) - jnp.take(csum, lo, axis=1)
    cnt = (hi - lo).astype(jnp.float32)[None, :, None]
    return (sums / cnt - pf).astype(p.dtype)


def _layer(x, w_in, b_in, ln_v_g, ln_v_b, w_spatial, b_spatial, w_pool, b_pool, pool_scale,
           w_br_a, w_br_b, w_out, b_out, ln_g, ln_b):
    bsz, s, _ = x.shape
    h = jnp.einsum('bsd,de->bse', x, w_in) + b_in
    u, v, z_a, p, z_b, g_a, g_b = jnp.split(h, SPLIT_POINTS, axis=-1)

    v = _layernorm(v, ln_v_g, ln_v_b)
    v = v.reshape(bsz, s // CHUNK, CHUNK, A_GROUPS, A_GROUP_W)
    v = jnp.einsum('bnpgc,gqp->bnqgc', v, w_spatial) + b_spatial.T[None, None, :, :, None]
    br_a = u * v.reshape(bsz, s, E_A) * jax.nn.silu(z_a)

    p = p.reshape(bsz, s, POOL_GROUPS, POOL_GROUP_W)
    pooled = jnp.stack([_centred_pool_minus_self(p[:, :, i, :], w) for i, w in enumerate(POOL_WINDOWS)], axis=2)
    m = jnp.einsum('bsgc,gcd->bsgd', pooled, w_pool) + b_pool
    br_b = m.reshape(bsz, s, E_B) * pool_scale * jax.nn.silu(z_b)

    merged = (jax.nn.sigmoid(g_a) * jnp.einsum('bse,ed->bsd', br_a, w_br_a)
              + jax.nn.sigmoid(g_b) * jnp.einsum('bse,ed->bsd', br_b, w_br_b))
    out = jnp.einsum('bsd,de->bse', merged, w_out) + b_out
    return _layernorm(DEEPNORM_ALPHA * x + out, ln_g, ln_b)


def _trunk(x, w_in, b_in, ln_v_g, ln_v_b, w_spatial, b_spatial, w_pool, b_pool, pool_scale,
           w_br_a, w_br_b, w_out, b_out, ln_g, ln_b):
    for l in range(DEPTH):
        x = _layer(x, w_in[l], b_in[l], ln_v_g[l], ln_v_b[l], w_spatial[l], b_spatial[l], w_pool[l],
                   b_pool[l], pool_scale[l], w_br_a[l], w_br_b[l], w_out[l], b_out[l], ln_g[l], ln_b[l])
    return x


def setup_inputs(seed: int = 0) -> dict:
    key = jax.random.key(seed)
    ks = jax.random.split(key, 20)
    n = jax.random.normal
    f32 = jnp.float32
    return {
        "x_prompt": n(ks[0], (BATCH, SEQ, D_MODEL), f32),
        "x_sample": n(ks[1], (DEC_BATCH, DEC_SEQ, D_MODEL), f32),
        "w_in": n(ks[2], (DEPTH, D_MODEL, IN_TOTAL), f32) * D_MODEL ** -0.5,
        "b_in": n(ks[3], (DEPTH, IN_TOTAL), f32) * 0.02,
        "ln_v_g": 1.0 + 0.05 * n(ks[4], (DEPTH, E_A), f32),
        "ln_v_b": 0.02 * n(ks[5], (DEPTH, E_A), f32),
        "w_spatial": n(ks[6], (DEPTH, A_GROUPS, CHUNK, CHUNK), f32) * CHUNK ** -0.5,
        "b_spatial": 1.0 + 0.05 * n(ks[7], (DEPTH, A_GROUPS, CHUNK), f32),
        "w_pool": n(ks[8], (DEPTH, POOL_GROUPS, POOL_GROUP_W, POOL_GROUP_W), f32) * POOL_GROUP_W ** -0.5,
        "b_pool": 0.02 * n(ks[9], (DEPTH, POOL_GROUPS, POOL_GROUP_W), f32),
        "pool_scale": 1.0 + 0.05 * n(ks[10], (DEPTH, E_B), f32),
        "w_br_a": n(ks[11], (DEPTH, E_A, D_MODEL), f32) * (E_A ** -0.5 * DEEPNORM_BETA),
        "w_br_b": n(ks[12], (DEPTH, E_B, D_MODEL), f32) * (E_B ** -0.5 * DEEPNORM_BETA),
        "w_out": n(ks[13], (DEPTH, D_MODEL, D_MODEL), f32) * (D_MODEL ** -0.5 * DEEPNORM_BETA),
        "b_out": 0.02 * n(ks[14], (DEPTH, D_MODEL), f32),
        "ln_g": 1.0 + 0.05 * n(ks[15], (DEPTH, D_MODEL), f32),
        "ln_b": 0.02 * n(ks[16], (DEPTH, D_MODEL), f32),
    }


def reference(x_prompt, x_sample, w_in, b_in, ln_v_g, ln_v_b, w_spatial, b_spatial, w_pool, b_pool,
              pool_scale, w_br_a, w_br_b, w_out, b_out, ln_g, ln_b):
    y_prompt = _trunk(x_prompt, w_in, b_in, ln_v_g, ln_v_b, w_spatial, b_spatial, w_pool, b_pool,
                      pool_scale, w_br_a, w_br_b, w_out, b_out, ln_g, ln_b)
    y_sample = _trunk(x_sample, w_in, b_in, ln_v_g, ln_v_b, w_spatial, b_spatial, w_pool, b_pool,
                      pool_scale, w_br_a, w_br_b, w_out, b_out, ln_g, ln_b)
    return (y_prompt, y_sample)
```

```cpp
#include <hip/hip_runtime.h>
#include <cstdio>
#include <cstdint>

#define LAS __attribute__((address_space(3)))
#define GAS __attribute__((address_space(1)))
typedef unsigned short bf16_t;
typedef short bf16x8 __attribute__((ext_vector_type(8)));
typedef float f32x4 __attribute__((ext_vector_type(4)));
typedef float f32x2 __attribute__((ext_vector_type(2)));
typedef unsigned u32x4 __attribute__((ext_vector_type(4)));
typedef unsigned u32x2 __attribute__((ext_vector_type(2)));
typedef GAS unsigned gu32;

#ifndef MK_N_LAUNCHES
#define MK_N_LAUNCHES 1
#endif
constexpr int N_PHASES = 6;

constexpr int D = 1024, NH = 7168, MTOK = 65536, MPROMPT = 32768, SEQ_P = 16384, SEQ_S = 2048;
constexpr float LN_EPS = 1e-5f;
constexpr float DN_ALPHA = 1.189207115002721f;

constexpr size_t MiB = 1u << 20;
constexpr size_t WS_CTL = 0, CTL_ZERO_BYTES = 1 * MiB;
constexpr size_t WS_WINT = 2 * MiB;
constexpr size_t WS_WAT = 16 * MiB, WS_WBT = 18 * MiB, WS_WOT = 20 * MiB;
constexpr size_t WS_WPT = 22 * MiB;
constexpr size_t WS_WS = WS_WPT + 512 * 1024;
constexpr size_t WS_BIASP = WS_WS + 256 * 1024;
constexpr size_t WS_STATS = 24 * MiB;
constexpr size_t WS_XB = 32 * MiB;
constexpr size_t PLANE = 128 * MiB;
constexpr size_t WS_T = 160 * MiB, WS_V = WS_T + PLANE, WS_P = WS_V + PLANE, WS_SZB = WS_P + PLANE, WS_RA = WS_SZB + PLANE, WS_GB = WS_RA + PLANE;
constexpr size_t WS_MERGED = WS_V;
constexpr size_t WS_END = WS_GB + PLANE;
constexpr int CW_BAR = 4096;

constexpr int RING_BYTES = 131072;
constexpr int LDSCTL_OFF = RING_BYTES, MISC_OFF = LDSCTL_OFF + 320;
constexpr int LDS_BYTES = 147456;

__device__ __forceinline__ unsigned cvt_pk_bf16(float lo, float hi) { unsigned r; asm volatile("v_cvt_pk_bf16_f32 %0, %1, %2" : "=v"(r) : "v"(lo), "v"(hi)); return r; }
__device__ __forceinline__ float bf_lo(unsigned w) { return __uint_as_float(w << 16); }
__device__ __forceinline__ float bf_hi(unsigned w) { return __uint_as_float(w & 0xffff0000u); }
__device__ __forceinline__ float fast_rcp(float x) { return __builtin_amdgcn_rcpf(x); }
__device__ __forceinline__ float exp_neg(float x) { return __expf(fminf(-x, 60.f)); }
__device__ __forceinline__ float silu_f(float z) { return z * fast_rcp(1.0f + exp_neg(z)); }

namespace pg8 {
constexpr int BM = 256, BK = 64, HALF = 128, HTB = HALF * BK * 2, STAGE_BYTES = 8 * HTB, NXCD = 8, WGM = 8, KDIM = 1024;

__host__ __device__ __forceinline__ int lds_byte(int r, int c) { const int st = (r >> 4) * 2 + (c >> 5), rr = r & 15, cc = c & 31, ob = rr * 64 + cc * 2; return st * 1024 + (ob ^ (((ob >> 9) & 1) << 5)); }
__host__ __device__ __forceinline__ void stage_rc(int b, int& R, int& C) { const int st = b / 1024, sb = b % 1024, swz = sb ^ (((sb >> 9) & 1) << 5); R = (st >> 1) * 16 + swz / 64; C = (st & 1) * 32 + (swz % 64) / 2; }
__host__ __device__ __forceinline__ int perm32(int rho) { const int n = rho >> 4, i = rho & 15; return 8 * (i >> 2) + 4 * n + (i & 3); }

struct Unit { int pm, pn, sub; };

struct StaticOrder {
    int nM, nN, nwg, G, c;
    __device__ __forceinline__ void init(int M, int N, int G_, int c_) { nM = M / BM; nN = N / BM; nwg = nM * nN; G = G_; c = c_; }
    __device__ __forceinline__ bool at(long L, Unit& u) const {
        if (L >= nwg) return false;
        int wgid = (int)L; { const int q = nwg / NXCD, r = nwg % NXCD, xcd = wgid % NXCD, off = wgid / NXCD; wgid = (xcd < r ? xcd * (q + 1) : r * (q + 1) + (xcd - r) * q) + off; }
        const int nig = WGM * nN, gid = wgid / nig, fm = gid * WGM, gsz = (nM - fm) < WGM ? (nM - fm) : WGM;
        u.pm = fm + ((wgid % nig) % gsz); u.pn = (wgid % nig) / gsz; u.sub = 0; return true;
    }
    __device__ __forceinline__ bool next(int i, Unit& u) const { return at((long)i * G + c, u); }
};

template <class Prob, bool ALIGN_EPI, bool SP2>
__device__ __forceinline__ void gemm_phase(LAS unsigned char* lds, const Prob& P) {
    const int tid = threadIdx.x, wid = __builtin_amdgcn_readfirstlane(tid >> 6), lane = tid & 63, wr = wid >> 2, wc = wid & 3, fr = lane & 15, fq = lane >> 4;
    constexpr int K = KDIM, nt = K / BK;
    unsigned voffA[2], voffB[2];
#pragma unroll
    for (int i = 0; i < 2; ++i) { int R, C; stage_rc(tid * 16 + i * 8192, R, C); const int Rb = Prob::PERM ? ((R & ~31) + perm32(R & 31)) : R;
        voffA[i] = (unsigned)(R * K + C) * 2u; voffB[i] = (unsigned)(Rb * K + C) * 2u; }
    const size_t kstep = (size_t)(BK * 2);
    const size_t hstep = (size_t)HALF * K * 2;
    const unsigned ldsw = (unsigned)wid * 1024u;
    const int aoff = lds_byte(wr * 64 + fr, fq * 8), boff = lds_byte(wc * 32 + fr, fq * 8);
#define PG8_SA(b, h) (((b) * 2 + (h)) * HTB)
#define PG8_SB(b, h) ((4 + (b) * 2 + (h)) * HTB)
#define PG8_STAGE(bufoff, gbase, voff) do { _Pragma("unroll") for (int _i = 0; _i < 2; ++_i) \
        __builtin_amdgcn_global_load_lds((const unsigned*)((const char*)(gbase) + (voff)[_i]), (LAS unsigned*)(lds + (bufoff) + ldsw + _i * 8192), 16, 0, 0); } while (0)
#define PG8_LDA(dst, b, h) do { _Pragma("unroll") for (int m = 0; m < 4; ++m) _Pragma("unroll") for (int k = 0; k < 2; ++k) dst[m][k] = *(const LAS bf16x8*)(lds + PG8_SA(b, h) + aoff + m * 2048 + k * 1024); } while (0)
#define PG8_LDB(dst, b, h) do { _Pragma("unroll") for (int n = 0; n < 2; ++n) _Pragma("unroll") for (int k = 0; k < 2; ++k) dst[n][k] = *(const LAS bf16x8*)(lds + PG8_SB(b, h) + boff + n * 2048 + k * 1024); } while (0)
#define PG8_MMA(ai, bj, At, Bt) do { __builtin_amdgcn_s_setprio(1); _Pragma("unroll") for (int m = 0; m < 4; ++m) _Pragma("unroll") for (int n = 0; n < 2; ++n) _Pragma("unroll") for (int k = 0; k < 2; ++k) \
        acc[ai][bj][m][n] = __builtin_amdgcn_mfma_f32_16x16x32_bf16(Bt[n][k], At[m][k], acc[ai][bj][m][n], 0, 0, 0); __builtin_amdgcn_s_setprio(0); } while (0)
#define PG8_WAIT_V(n) asm volatile("s_waitcnt vmcnt(" #n ")" ::: "memory")
#define PG8_WAIT_L(n) asm volatile("s_waitcnt lgkmcnt(" #n ")" ::: "memory")
#define PG8_BAR __builtin_amdgcn_s_barrier()
#define PG8_SCHED __builtin_amdgcn_sched_barrier(0)
#define PG8_ZERO() do { _Pragma("unroll") for (int a = 0; a < 2; ++a) _Pragma("unroll") for (int b = 0; b < 2; ++b) _Pragma("unroll") for (int m = 0; m < 4; ++m) _Pragma("unroll") for (int n = 0; n < 2; ++n) acc[a][b][m][n] = (f32x4){0.f, 0.f, 0.f, 0.f}; } while (0)
    Unit cur, nxt; int ui = 0;
    if (!P.next(0, cur)) return;
    f32x4 acc[2][2][4][2];
    PG8_ZERO();
    bf16x8 At[4][2], B0[2][2], B1[2][2];
    const char* cA = P.a_ptr(cur); const char* cB = P.b_ptr(cur);
    if constexpr (SP2) {
        PG8_STAGE(PG8_SB(0, 0), cB, voffB); PG8_STAGE(PG8_SB(0, 1), cB + hstep, voffB); PG8_STAGE(PG8_SA(0, 0), cA, voffA); PG8_STAGE(PG8_SA(0, 1), cA + hstep, voffA);
        if (wr == 1) PG8_BAR;
        PG8_WAIT_V(2); PG8_BAR;
        PG8_STAGE(PG8_SB(1, 0), cB + kstep, voffB); PG8_STAGE(PG8_SA(1, 0), cA + kstep, voffA); PG8_STAGE(PG8_SB(1, 1), cB + hstep + kstep, voffB);
        PG8_WAIT_V(6); PG8_BAR;
    } else {
        PG8_STAGE(PG8_SB(0, 0), cB, voffB); PG8_STAGE(PG8_SA(0, 0), cA, voffA); PG8_STAGE(PG8_SB(0, 1), cB + hstep, voffB); PG8_STAGE(PG8_SA(0, 1), cA + hstep, voffA);
        if (wr == 1) PG8_BAR;
        PG8_WAIT_V(4); PG8_BAR;
        PG8_STAGE(PG8_SB(1, 0), cB + kstep, voffB); PG8_STAGE(PG8_SA(1, 0), cA + kstep, voffA); PG8_STAGE(PG8_SB(1, 1), cB + hstep + kstep, voffB);
        PG8_WAIT_V(6); PG8_BAR;
    }
    for (;;) {
        const bool has_next = P.next(ui + 1, nxt);
        const char* nA = has_next ? P.a_ptr(nxt) : cA; const char* nB = has_next ? P.b_ptr(nxt) : cB;
        for (int t = 0; t < nt; t += 2) {
            const bool last = (t == nt - 2);
            const char* a1 = cA + (size_t)(t + 1) * kstep;
            const char* a2 = last ? nA : cA + (size_t)(t + 2) * kstep; const char* b2 = last ? nB : cB + (size_t)(t + 2) * kstep;
            const char* a3 = a2 + kstep; const char* b3 = b2 + kstep;
            if constexpr (SP2) {
            PG8_LDB(B0, 0, 0); PG8_LDB(B1, 0, 1); PG8_SCHED; PG8_LDA(At, 0, 0); PG8_STAGE(PG8_SA(1, 1), a1 + hstep, voffA);
            PG8_WAIT_V(8); PG8_WAIT_L(0); PG8_BAR; PG8_MMA(0, 0, At, B0); PG8_MMA(0, 1, At, B1); PG8_BAR; PG8_SCHED;
            PG8_LDA(At, 0, 1); PG8_STAGE(PG8_SB(0, 0), b2, voffB); PG8_STAGE(PG8_SB(0, 1), b2 + hstep, voffB); PG8_STAGE(PG8_SA(0, 0), a2, voffA);
            PG8_WAIT_V(8); PG8_WAIT_L(0); PG8_BAR; PG8_MMA(1, 0, At, B0); PG8_MMA(1, 1, At, B1); PG8_BAR; PG8_SCHED;
            PG8_LDB(B0, 1, 0); PG8_LDB(B1, 1, 1); PG8_SCHED; PG8_LDA(At, 1, 0); PG8_STAGE(PG8_SA(0, 1), a2 + hstep, voffA);
            PG8_WAIT_V(8); PG8_WAIT_L(0); PG8_BAR; PG8_MMA(0, 0, At, B0); PG8_MMA(0, 1, At, B1); PG8_BAR; PG8_SCHED;
            PG8_LDA(At, 1, 1); PG8_STAGE(PG8_SB(1, 0), b3, voffB); PG8_STAGE(PG8_SB(1, 1), b3 + hstep, voffB); PG8_STAGE(PG8_SA(1, 0), a3, voffA);
            PG8_WAIT_V(8); PG8_WAIT_L(0); PG8_BAR; PG8_MMA(1, 0, At, B0); PG8_MMA(1, 1, At, B1); PG8_BAR; PG8_SCHED;
            } else {
            PG8_LDB(B0, 0, 0); PG8_SCHED; PG8_LDA(At, 0, 0); PG8_STAGE(PG8_SA(1, 1), a1 + hstep, voffA);
            PG8_WAIT_L(8); PG8_BAR; PG8_WAIT_L(0); PG8_MMA(0, 0, At, B0); PG8_BAR; PG8_SCHED;
            PG8_LDB(B1, 0, 1); PG8_STAGE(PG8_SB(0, 0), b2, voffB);
            PG8_BAR; PG8_WAIT_L(0); PG8_MMA(0, 1, At, B1); PG8_BAR;
            PG8_LDA(At, 0, 1); PG8_STAGE(PG8_SA(0, 0), a2, voffA);
            PG8_BAR; PG8_WAIT_L(0); PG8_MMA(1, 0, At, B0); PG8_BAR; PG8_SCHED;
            PG8_STAGE(PG8_SB(0, 1), b2 + hstep, voffB);
            PG8_WAIT_V(6); PG8_BAR; PG8_MMA(1, 1, At, B1); PG8_BAR;
            PG8_LDB(B0, 1, 0); PG8_SCHED; PG8_LDA(At, 1, 0); PG8_STAGE(PG8_SA(0, 1), a2 + hstep, voffA);
            PG8_WAIT_L(8); PG8_BAR; PG8_WAIT_L(0); PG8_MMA(0, 0, At, B0); PG8_BAR; PG8_SCHED;
            PG8_LDB(B1, 1, 1); PG8_STAGE(PG8_SB(1, 0), b3, voffB);
            PG8_BAR; PG8_WAIT_L(0); PG8_MMA(0, 1, At, B1); PG8_BAR;
            PG8_LDA(At, 1, 1); PG8_STAGE(PG8_SA(1, 0), a3, voffA);
            PG8_BAR; PG8_WAIT_L(0); PG8_MMA(1, 0, At, B0); PG8_BAR; PG8_SCHED;
            PG8_STAGE(PG8_SB(1, 1), b3 + hstep, voffB);
            PG8_WAIT_V(6); PG8_BAR; PG8_MMA(1, 1, At, B1); PG8_BAR;
            }
        }
        if constexpr (ALIGN_EPI) { if (wr == 0) PG8_BAR; }
        const bool chain = P.chain(cur);
        P.post(acc, cur, chain, wr, wc, fr, fq);
        if (!has_next) break;
        if (!chain) PG8_ZERO();
        cur = nxt; cA = nA; cB = nB; ++ui;
        if constexpr (ALIGN_EPI) { if (wr == 1) PG8_BAR; }
    }
    PG8_WAIT_V(0);
    if constexpr (!ALIGN_EPI) { if (wr == 0) PG8_BAR; }
    PG8_BAR;
#undef PG8_SA
#undef PG8_SB
#undef PG8_STAGE
#undef PG8_LDA
#undef PG8_LDB
#undef PG8_MMA
#undef PG8_WAIT_V
#undef PG8_WAIT_L
#undef PG8_BAR
#undef PG8_SCHED
#undef PG8_ZERO
}
}

#define RLX_AGENT __ATOMIC_RELAXED, __HIP_MEMORY_SCOPE_AGENT
#define LDS_WAIT() asm volatile("s_waitcnt lgkmcnt(0)" ::: "memory")
#define VM_WAIT() asm volatile("s_waitcnt vmcnt(0)" ::: "memory")

#define XB_TMO      128
#define XB_XCNT(j)  (256  + 64 * (j))
#define XB_XSUB(j)  (1280 + 64 * (j))
#define XB_XGEN(j)  (2304 + 64 * (j))
#define XB_TOP      3328
#define XB_TOPGEN   3392
#define XCD_BAR_WORDS 3456
#define XB_SPIN_CAP (1u << 18)
__device__ __forceinline__ unsigned xb_ld(unsigned* p)              { return __hip_atomic_load(p, __ATOMIC_RELAXED, __HIP_MEMORY_SCOPE_AGENT); }
__device__ __forceinline__ unsigned xb_add(unsigned* p, unsigned v) { return __hip_atomic_fetch_add(p, v, __ATOMIC_RELAXED, __HIP_MEMORY_SCOPE_AGENT); }
__device__ __forceinline__ unsigned xb_xcc_id() { return (unsigned)__builtin_amdgcn_s_getreg((3 << 11) | 20) & 0xFu; }
#define XB_SPIN(cond, bar) do { unsigned _sp = 0; while (cond) { __builtin_amdgcn_s_sleep(1); \
    if ((++_sp & 255u) == 0u) { if (xb_ld(&(bar)[XB_TMO])) break; if (_sp > XB_SPIN_CAP) { atomicAdd(&(bar)[XB_TMO], 1u); break; } } } } while (0)
struct XcdBarrier { unsigned* bar; unsigned x; volatile LAS unsigned* st; };
__device__ __forceinline__ XcdBarrier xcd_barrier_post(unsigned* bar, volatile LAS unsigned* st) {
    XcdBarrier b; b.bar = bar; b.x = xb_xcc_id(); b.st = st;
    if (threadIdx.x == 0) (void)xb_add(&bar[XB_XCNT(b.x)], 1u);
    return b;
}
__device__ __forceinline__ void xcd_barrier_complete(unsigned* bar, unsigned x, unsigned& nloc, unsigned& nx) {
    const unsigned G = gridDim.x * gridDim.y * gridDim.z;
    unsigned sum, cnt, mine, sp = 0u;
    for (;;) {
        sum = 0u; cnt = 0u; mine = 0u;
#pragma unroll
        for (unsigned j = 0; j < 16; ++j) { const unsigned c = xb_ld(&bar[XB_XCNT(j)]); sum += c; cnt += (c > 0u) ? 1u : 0u; mine = (j == x) ? c : mine; }
        if (sum == G) break;
        __builtin_amdgcn_s_sleep(1);
        if ((++sp & 255u) == 0u) { if (xb_ld(&bar[XB_TMO])) break; if (sp > XB_SPIN_CAP) { atomicAdd(&bar[XB_TMO], 1u); break; } }
    }
    nloc = mine > 0u ? mine : 1u; nx = cnt > 0u ? cnt : 1u;
}
__device__ __forceinline__ void xcd_barrier(const XcdBarrier& b) {
    asm volatile("s_waitcnt vmcnt(0)" ::: "memory");
    __syncthreads();
    if (threadIdx.x == 0) {
        unsigned* bar = b.bar;
        __builtin_amdgcn_s_waitcnt(0);
        unsigned nloc = b.st[0], nx = b.st[1];
        if (nloc == 0u) { xcd_barrier_complete(bar, b.x, nloc, nx); b.st[0] = nloc; b.st[1] = nx; }
        const unsigned old = xb_add(&bar[XB_XSUB(b.x)], 1u);
        const unsigned gen = old / nloc;
        if (old + 1u == (gen + 1u) * nloc) {
            __builtin_amdgcn_fence(__ATOMIC_RELEASE, "agent");
            asm volatile("s_waitcnt vmcnt(0)" ::: "memory");
            const unsigned og = xb_add(&bar[XB_TOP], 1u);
            const unsigned tg = og / nx;
            if (og + 1u == (tg + 1u) * nx) xb_add(&bar[XB_TOPGEN], 1u);
            else XB_SPIN(xb_ld(&bar[XB_TOPGEN]) == tg, bar);
            __builtin_amdgcn_fence(__ATOMIC_ACQUIRE, "agent");
            xb_add(&bar[XB_XGEN(b.x)], 1u);
            asm volatile("s_waitcnt vmcnt(0)" ::: "memory");
        } else {
            XB_SPIN(xb_ld(&bar[XB_XGEN(b.x)]) == gen, bar);
            __builtin_amdgcn_fence(__ATOMIC_ACQUIRE, "agent");
            asm volatile("s_waitcnt vmcnt(0)" ::: "memory");
        }
    }
    __syncthreads();
}

struct Args {
    const float* x_prompt; const float* x_sample; const float* w_in; const float* b_in; const float* ln_v_g; const float* ln_v_b;
    const float* w_spatial; const float* b_spatial; const float* w_pool; const float* b_pool; const float* pool_scale;
    const float* w_br_a; const float* w_br_b; const float* w_out; const float* b_out; const float* ln_g; const float* ln_b;
    float* out; unsigned char* ws; int ph_lo, ph_hi;
};

__device__ __forceinline__ const float* x_row(const Args& a, int m) { return m < MPROMPT ? a.x_prompt + (size_t)m * D : a.x_sample + (size_t)(m - MPROMPT) * D; }

__device__ __forceinline__ int win_row_of_col(int n) {
    if (n < 1024) return 256 * (n >> 7) + (n & 127);
    if (n < 2048) return 2048 + (n - 1024);
    if (n < 3072) { const int j = n - 2048; return 256 * (j >> 7) + 128 + (j & 127); }
    if (n < 5120) return n;
    if (n < 6144) { const int j = n - 5120; return 5120 + 256 * (j >> 7) + (j & 127); }
    { const int j = n - 6144; return 5120 + 256 * (j >> 7) + 128 + (j & 127); }
}
template <bool WIN_MAP>
__device__ __forceinline__ void p0_transpose_item(const float* W, int K, int N, bf16_t* WT, int row_off, LAS float* scr, int item, int lane) {
    const int nblk = N / 32, kb = item / nblk, nb = item % nblk, k0 = 64 * kb, n0 = 32 * nb;
#pragma unroll 8
    for (int i = 0; i < 32; ++i) { const int kk = 2 * i + (lane >> 5); scr[kk * 33 + (lane & 31)] = W[(size_t)(k0 + kk) * N + n0 + (lane & 31)]; }
    LDS_WAIT(); asm volatile("" ::: "memory");
    const int c = lane & 7;
    const int r0 = WIN_MAP ? win_row_of_col(n0) : (row_off + n0);
#pragma unroll
    for (int j = 0; j < 4; ++j) { const int n = (lane >> 3) + 8 * j; const LAS float* s = scr + (8 * c) * 33 + n;
        u32x4 o; o.x = cvt_pk_bf16(s[0 * 33], s[1 * 33]); o.y = cvt_pk_bf16(s[2 * 33], s[3 * 33]); o.z = cvt_pk_bf16(s[4 * 33], s[5 * 33]); o.w = cvt_pk_bf16(s[6 * 33], s[7 * 33]);
        *(u32x4*)(WT + (size_t)(r0 + n) * K + k0 + 8 * c) = o; }
    LDS_WAIT(); asm volatile("" ::: "memory");
}

__device__ __forceinline__ void p0_prologue(const Args& a, LAS unsigned char* lds, int vcu, int G, int tid, int wave, int lane) {
    unsigned char* ws = a.ws;
    LAS float* scr = (LAS float*)(lds + wave * 16384);
    const int gw = vcu * 8 + wave, NGW = G * 8;
    constexpr int I_IN = (D / 64) * (NH / 32), I_SQ = (D / 64) * (D / 32), I_PL = (256 / 64) * (256 / 32);
    constexpr int NITEMS = I_IN + 3 * I_SQ + 4 * I_PL;
    for (int it = gw; it < NITEMS; it += NGW) {
        int r = it;
        if (r < I_IN) { p0_transpose_item<true>(a.w_in, D, NH, (bf16_t*)(ws + WS_WINT), 0, scr, r, lane); continue; } r -= I_IN;
        if (r < I_SQ) { p0_transpose_item<false>(a.w_br_a, D, D, (bf16_t*)(ws + WS_WAT), 0, scr, r, lane); continue; } r -= I_SQ;
        if (r < I_SQ) { p0_transpose_item<false>(a.w_br_b, D, D, (bf16_t*)(ws + WS_WBT), 0, scr, r, lane); continue; } r -= I_SQ;
        if (r < I_SQ) { p0_transpose_item<false>(a.w_out, D, D, (bf16_t*)(ws + WS_WOT), 0, scr, r, lane); continue; } r -= I_SQ;
        { const int g = r / I_PL, rr = r % I_PL; p0_transpose_item<false>(a.w_pool + (size_t)g * 65536, 256, 256, (bf16_t*)(ws + WS_WPT) + (size_t)g * 65536, 0, scr, rr, lane); }
    }
    const int gt = vcu * 512 + tid, NGT = G * 512;
    for (int i = gt; i < 8 * 128 * 128 / 4; i += NGT) { const f32x4 v = *(const f32x4*)(a.w_spatial + (size_t)i * 4); u32x2 o; o.x = cvt_pk_bf16(v.x, v.y); o.y = cvt_pk_bf16(v.z, v.w); *(u32x2*)((bf16_t*)(ws + WS_WS) + (size_t)i * 4) = o; }
    for (int n = gt; n < NH; n += NGT) { const int r = win_row_of_col(n & ~31) + (n & 31); ((float*)(ws + WS_BIASP))[r] = a.b_in[n]; }
    bf16_t* XB = (bf16_t*)(ws + WS_XB);
    constexpr int NV8 = MTOK * D / 8, HALF8 = MPROMPT * D / 8;
    for (int i = gt; i < NV8; i += 4 * NGT) {
        f32x4 v[4][2];
#pragma unroll
        for (int j = 0; j < 4; ++j) { const int idx = min(i + j * NGT, NV8 - 1); const float* src = idx < HALF8 ? a.x_prompt + (size_t)idx * 8 : a.x_sample + (size_t)(idx - HALF8) * 8;
            v[j][0] = *(const f32x4*)src; v[j][1] = *(const f32x4*)(src + 4); }
#pragma unroll
        for (int j = 0; j < 4; ++j) { const int idx = min(i + j * NGT, NV8 - 1); u32x4 o; o.x = cvt_pk_bf16(v[j][0].x, v[j][0].y); o.y = cvt_pk_bf16(v[j][0].z, v[j][0].w); o.z = cvt_pk_bf16(v[j][1].x, v[j][1].y); o.w = cvt_pk_bf16(v[j][1].z, v[j][1].w);
            *(u32x4*)(XB + (size_t)idx * 8) = o; }
    }
}

struct P1Prob {
    static constexpr bool PERM = true;
    const bf16_t* XB; const bf16_t* WinT; const float* biasp;
    bf16_t *T, *V, *RA, *GB; f32x2* STATS;
    pg8::StaticOrder S;
    __device__ __forceinline__ bool next(int i, pg8::Unit& u) const { return S.next(i, u); }
    __device__ __forceinline__ const char* a_ptr(const pg8::Unit& u) const { return (const char*)XB + (size_t)u.pm * (256 * 1024 * 2); }
    __device__ __forceinline__ const char* b_ptr(const pg8::Unit& u) const { return (const char*)WinT + (size_t)u.pn * (256 * 1024 * 2); }
    __device__ __forceinline__ bool chain(const pg8::Unit&) const { return false; }
    __device__ __forceinline__ void post(f32x4 (&acc)[2][2][4][2], const pg8::Unit& u, bool, int wr, int wc, int fr, int fq) const {
        const int pn = u.pn, row0 = u.pm * 256 + wr * 64 + fr, cw = wc * 32 + 8 * fq;
        f32x4 bv[2][2];
#pragma unroll
        for (int bj = 0; bj < 2; ++bj)
#pragma unroll
            for (int n = 0; n < 2; ++n) bv[bj][n] = *(const f32x4*)(biasp + pn * 256 + bj * 128 + cw + 4 * n);
        if (pn < 8) {
            bf16_t* base = T + (size_t)row0 * D + pn * 128 + cw;
#pragma unroll
            for (int ai = 0; ai < 2; ++ai)
#pragma unroll
                for (int m = 0; m < 4; ++m) {
                    const f32x4 u0 = acc[ai][0][m][0] + bv[0][0], u1 = acc[ai][0][m][1] + bv[0][1], z0 = acc[ai][1][m][0] + bv[1][0], z1 = acc[ai][1][m][1] + bv[1][1];
                    u32x4 w; w.x = cvt_pk_bf16(u0[0] * silu_f(z0[0]), u0[1] * silu_f(z0[1])); w.y = cvt_pk_bf16(u0[2] * silu_f(z0[2]), u0[3] * silu_f(z0[3]));
                    w.z = cvt_pk_bf16(u1[0] * silu_f(z1[0]), u1[1] * silu_f(z1[1])); w.w = cvt_pk_bf16(u1[2] * silu_f(z1[2]), u1[3] * silu_f(z1[3]));
                    *(u32x4*)(base + (size_t)(ai * 128 + m * 16) * D) = w; }
        } else if (pn < 20) {
            const int kind = (pn - 8) >> 2, t = (pn - 8) & 3;
            bf16_t* base = V + (size_t)kind * (PLANE / 2) + (size_t)row0 * D + t * 256 + cw;
#pragma unroll
            for (int ai = 0; ai < 2; ++ai)
#pragma unroll
                for (int m = 0; m < 4; ++m) {
                    f32x4 v[2][2];
#pragma unroll
                    for (int bj = 0; bj < 2; ++bj) {
                        v[bj][0] = acc[ai][bj][m][0] + bv[bj][0]; v[bj][1] = acc[ai][bj][m][1] + bv[bj][1];
                        f32x4 o0 = v[bj][0], o1 = v[bj][1];
                        if (kind == 2) {
#pragma unroll
                            for (int e = 0; e < 4; ++e) { o0[e] = silu_f(o0[e]); o1[e] = silu_f(o1[e]); } }
                        u32x4 w; w.x = cvt_pk_bf16(o0[0], o0[1]); w.y = cvt_pk_bf16(o0[2], o0[3]); w.z = cvt_pk_bf16(o1[0], o1[1]); w.w = cvt_pk_bf16(o1[2], o1[3]);
                        *(u32x4*)(base + (size_t)(ai * 128 + m * 16) * D + bj * 128) = w; }
                    if (kind == 0) {
                        float s = 0.f;
#pragma unroll
                        for (int bj = 0; bj < 2; ++bj)
#pragma unroll
                            for (int n = 0; n < 2; ++n) s += (v[bj][n][0] + v[bj][n][1]) + (v[bj][n][2] + v[bj][n][3]);
                        s += __shfl_xor(s, 16); s += __shfl_xor(s, 32);
                        const float mw = s * (1.0f / 64.0f); float q = 0.f;
#pragma unroll
                        for (int bj = 0; bj < 2; ++bj)
#pragma unroll
                            for (int n = 0; n < 2; ++n) { const f32x4 d = v[bj][n] - mw; q += (d[0] * d[0] + d[1] * d[1]) + (d[2] * d[2] + d[3] * d[3]); }
                        q += __shfl_xor(q, 16); q += __shfl_xor(q, 32);
                        if (fq == 0) STATS[(size_t)(row0 + ai * 128 + m * 16) * 16 + t * 4 + wc] = (f32x2){mw, q};
                    } }
        } else {
            const size_t off0 = (size_t)row0 * D + (pn - 20) * 128 + cw;
#pragma unroll
            for (int ai = 0; ai < 2; ++ai)
#pragma unroll
                for (int m = 0; m < 4; ++m) {
                    float ra[8], gb[8];
#pragma unroll
                    for (int n = 0; n < 2; ++n)
#pragma unroll
                        for (int e = 0; e < 4; ++e) { const float ga_ = acc[ai][0][m][n][e] + bv[0][n][e], gb_ = acc[ai][1][m][n][e] + bv[1][n][e];
                            const float ea = exp_neg(ga_), eb = exp_neg(gb_); gb[n * 4 + e] = fast_rcp(1.0f + eb); ra[n * 4 + e] = (1.0f + eb) * fast_rcp(1.0f + ea); }
                    const size_t off = off0 + (size_t)(ai * 128 + m * 16) * D;
                    u32x4 w; w.x = cvt_pk_bf16(ra[0], ra[1]); w.y = cvt_pk_bf16(ra[2], ra[3]); w.z = cvt_pk_bf16(ra[4], ra[5]); w.w = cvt_pk_bf16(ra[6], ra[7]);
                    *(u32x4*)(RA + off) = w;
                    w.x = cvt_pk_bf16(gb[0], gb[1]); w.y = cvt_pk_bf16(gb[2], gb[3]); w.z = cvt_pk_bf16(gb[4], gb[5]); w.w = cvt_pk_bf16(gb[6], gb[7]);
                    *(u32x4*)(GB + off) = w; }
        }
    }
};

struct P3Prob {
    static constexpr bool PERM = true;
    const bf16_t *BRA, *WaT, *RA; bf16_t* MERGED;
    pg8::StaticOrder S;
    __device__ __forceinline__ bool next(int i, pg8::Unit& u) const { const bool ok = S.next(i >> 1, u); u.sub = i & 1; return ok; }
    __device__ __forceinline__ const char* a_ptr(const pg8::Unit& u) const { return (const char*)BRA + (size_t)u.sub * (WS_SZB - WS_T) + (size_t)u.pm * (256 * 1024 * 2); }
    __device__ __forceinline__ const char* b_ptr(const pg8::Unit& u) const { return (const char*)WaT + (size_t)u.sub * (WS_WBT - WS_WAT) + (size_t)u.pn * (256 * 1024 * 2); }
    __device__ __forceinline__ bool chain(const pg8::Unit& u) const { return u.sub == 0; }
    __device__ __forceinline__ void post(f32x4 (&acc)[2][2][4][2], const pg8::Unit& u, bool chain_, int wr, int wc, int fr, int fq) const {
        const size_t off0 = (size_t)(u.pm * 256 + wr * 64 + fr) * D + u.pn * 256 + wc * 32 + 8 * fq;
        const bf16_t* gate = (const bf16_t*)((const char*)RA + (chain_ ? (size_t)0 : PLANE)) + off0;
#pragma unroll
        for (int ai = 0; ai < 2; ++ai)
#pragma unroll
            for (int m = 0; m < 4; ++m)
#pragma unroll
                for (int bj = 0; bj < 2; ++bj) { const u32x4 w = *(const u32x4*)(gate + (size_t)(ai * 128 + m * 16) * D + bj * 128);
                    acc[ai][bj][m][0][0] *= bf_lo(w.x); acc[ai][bj][m][0][1] *= bf_hi(w.x); acc[ai][bj][m][0][2] *= bf_lo(w.y); acc[ai][bj][m][0][3] *= bf_hi(w.y);
                    acc[ai][bj][m][1][0] *= bf_lo(w.z); acc[ai][bj][m][1][1] *= bf_hi(w.z); acc[ai][bj][m][1][2] *= bf_lo(w.w); acc[ai][bj][m][1][3] *= bf_hi(w.w);
                    if (bj == 1) asm volatile("" ::: "memory"); }
        if (!chain_) {
            bf16_t* base = MERGED + off0;
#pragma unroll
            for (int ai = 0; ai < 2; ++ai)
#pragma unroll
                for (int m = 0; m < 4; ++m)
#pragma unroll
                    for (int bj = 0; bj < 2; ++bj) { const f32x4 v0 = acc[ai][bj][m][0], v1 = acc[ai][bj][m][1];
                        u32x4 w; w.x = cvt_pk_bf16(v0[0], v0[1]); w.y = cvt_pk_bf16(v0[2], v0[3]); w.z = cvt_pk_bf16(v1[0], v1[1]); w.w = cvt_pk_bf16(v1[2], v1[3]);
                        *(u32x4*)(base + (size_t)(ai * 128 + m * 16) * D + bj * 128) = w; }
        }
    }
};

struct P4Prob {
    static constexpr bool PERM = false;
    const bf16_t *MERGED, *WoT; const float* bout; const float* xp; const float* xs; float* out;
    pg8::StaticOrder S;
    __device__ __forceinline__ bool next(int i, pg8::Unit& u) const { return S.next(i, u); }
    __device__ __forceinline__ const char* a_ptr(const pg8::Unit& u) const { return (const char*)MERGED + (size_t)u.pm * (256 * 1024 * 2); }
    __device__ __forceinline__ const char* b_ptr(const pg8::Unit& u) const { return (const char*)WoT + (size_t)u.pn * (256 * 1024 * 2); }
    __device__ __forceinline__ bool chain(const pg8::Unit&) const { return false; }
    __device__ __forceinline__ void post(f32x4 (&acc)[2][2][4][2], const pg8::Unit& u, bool, int wr, int wc, int fr, int fq) const {
        const int row0 = u.pm * 256 + wr * 64 + fr, col0 = u.pn * 256 + wc * 32 + 4 * fq;
        const float* xbase = (u.pm * 256 < MPROMPT) ? xp + (size_t)row0 * D : xs + (size_t)(row0 - MPROMPT) * D;
        f32x4 bv[2][2];
#pragma unroll
        for (int bj = 0; bj < 2; ++bj)
#pragma unroll
            for (int n = 0; n < 2; ++n) bv[bj][n] = *(const f32x4*)(bout + col0 + bj * 128 + n * 16);
#pragma unroll
        for (int ai = 0; ai < 2; ++ai)
#pragma unroll
            for (int m = 0; m < 4; ++m) { const size_t ro = (size_t)(ai * 128 + m * 16) * D;
#pragma unroll
                for (int bj = 0; bj < 2; ++bj)
#pragma unroll
                    for (int n = 0; n < 2; ++n) { const f32x4 xv = *(const f32x4*)(xbase + ro + col0 + bj * 128 + n * 16);
                        *(f32x4*)(out + (size_t)row0 * D + ro + col0 + bj * 128 + n * 16) = xv * DN_ALPHA + acc[ai][bj][m][n] + bv[bj][n]; } }
    }
};

__device__ __forceinline__ float wave_sum(float v) {
#pragma unroll
    for (int o = 1; o < 64; o <<= 1) v += __shfl_xor(v, o);
    return v;
}

constexpr int A_RAW = 0, A_LNT = 32768, A_STAT = A_LNT + 128 * 272;
__device__ __forceinline__ void p2_mixer_a(const Args& a, LAS unsigned char* lds, int bid, int tid, int wave, int lane) {
    unsigned char* ws = a.ws;
    bf16_t* T = (bf16_t*)(ws + WS_T); const bf16_t* V = (const bf16_t*)(ws + WS_V); const f32x2* STATS = (const f32x2*)(ws + WS_STATS);
    const int g = bid & 7, fr = lane & 15, fq = lane >> 4;
    bf16x8 Wf[4];
    { const bf16_t* wsrow = (const bf16_t*)(ws + WS_WS) + ((size_t)g * 128 + 16 * wave + fr) * 128;
#pragma unroll
      for (int ks = 0; ks < 4; ++ks) { const u32x2 lo = *(const u32x2*)(wsrow + 16 * ks + 4 * fq), hi = *(const u32x2*)(wsrow + 64 + 16 * ks + 4 * fq);
          u32x4 w; w.x = (lo.x & 0xffffu) | (hi.x << 16); w.y = (lo.x >> 16) | (hi.x & 0xffff0000u); w.z = (lo.y & 0xffffu) | (hi.y << 16); w.w = (lo.y >> 16) | (hi.y & 0xffff0000u);
          Wf[ks] = __builtin_bit_cast(bf16x8, w); } }
    const float bsq = a.b_spatial[g * 128 + 16 * wave + fr];
    f32x4 gam[2][2], bet[2][2];
#pragma unroll
    for (int t = 0; t < 2; ++t) { const int c0 = g * 128 + 8 * (wave + 8 * t);
        gam[t][0] = *(const f32x4*)(a.ln_v_g + c0); gam[t][1] = *(const f32x4*)(a.ln_v_g + c0 + 4); bet[t][0] = *(const f32x4*)(a.ln_v_b + c0); bet[t][1] = *(const f32x4*)(a.ln_v_b + c0 + 4); }
    LAS f32x2* STAT = (LAS f32x2*)(lds + A_STAT);
    for (int j = 0; j < 16; ++j) {
        const int chunk = (bid >> 3) + 32 * j; const size_t row0 = (size_t)chunk * 128;
        if (tid < 128) { const f32x4* sp = (const f32x4*)(STATS + (row0 + tid) * 16); float mt[16], m2[16]; float ms = 0.f;
#pragma unroll
            for (int i = 0; i < 8; ++i) { const f32x4 w = sp[i]; mt[2 * i] = w.x; m2[2 * i] = w.y; mt[2 * i + 1] = w.z; m2[2 * i + 1] = w.w; ms += w.x + w.z; }
            const float mean = ms * (1.0f / 16.0f); float q = 0.f;
#pragma unroll
            for (int i = 0; i < 16; ++i) { const float dm = mt[i] - mean; q += m2[i] + 64.0f * dm * dm; }
            STAT[tid] = (f32x2){mean, 1.0f / sqrtf(q * (1.0f / 1024.0f) + LN_EPS)}; }
#pragma unroll
        for (int k = 0; k < 4; ++k) { const int idx = tid + 512 * k, p = idx >> 4, c = idx & 15;
            const u32x4 w = *(const u32x4*)(V + (row0 + p) * D + g * 128 + 8 * c);
            *(LAS u32x4*)(lds + A_RAW + p * 256 + 16 * (c ^ (p & 15))) = w; }
        __syncthreads();
        { const f32x2 s0 = STAT[lane], s1 = STAT[lane + 64];
#pragma unroll
          for (int t = 0; t < 2; ++t) { const int c16 = wave + 8 * t;
              const u32x4 r0 = *(const LAS u32x4*)(lds + A_RAW + lane * 256 + 16 * (c16 ^ (lane & 15))), r1 = *(const LAS u32x4*)(lds + A_RAW + (lane + 64) * 256 + 16 * (c16 ^ (lane & 15)));
              const unsigned w0[4] = {r0.x, r0.y, r0.z, r0.w}, w1[4] = {r1.x, r1.y, r1.z, r1.w};
#pragma unroll
              for (int jj = 0; jj < 8; ++jj) { const unsigned a0 = w0[jj >> 1], a1 = w1[jj >> 1];
                  const float v0 = (jj & 1) ? bf_hi(a0) : bf_lo(a0), v1 = (jj & 1) ? bf_hi(a1) : bf_lo(a1);
                  const float gm = gam[t][jj >> 2][jj & 3], bt = bet[t][jj >> 2][jj & 3];
                  const float y0 = (v0 - s0.x) * s0.y * gm + bt, y1 = (v1 - s1.x) * s1.y * gm + bt;
                  const int slot = 32 * (c16 >> 2) + 16 * (jj >> 2) + 4 * (c16 & 3) + (jj & 3);
                  *(LAS unsigned*)(lds + A_LNT + slot * 272 + 4 * lane) = cvt_pk_bf16(y0, y1); } } }
        __syncthreads();
#pragma unroll
        for (int Gc = 0; Gc < 4; ++Gc) {
            f32x4 acc[2] = {(f32x4){0.f, 0.f, 0.f, 0.f}, (f32x4){0.f, 0.f, 0.f, 0.f}};
#pragma unroll
            for (int n = 0; n < 2; ++n)
#pragma unroll
                for (int ks = 0; ks < 4; ++ks) { const bf16x8 X = *(const LAS bf16x8*)(lds + A_LNT + (32 * Gc + 16 * n + fr) * 272 + 64 * ks + 16 * fq);
                    acc[n] = __builtin_amdgcn_mfma_f32_16x16x32_bf16(X, Wf[ks], acc[n], 0, 0, 0); }
            bf16_t* tp = T + (row0 + 16 * wave + fr) * D + g * 128 + 32 * Gc + 8 * fq;
            const u32x4 w = *(const u32x4*)tp;
            u32x4 o; o.x = cvt_pk_bf16(bf_lo(w.x) * (acc[0][0] + bsq), bf_hi(w.x) * (acc[0][1] + bsq)); o.y = cvt_pk_bf16(bf_lo(w.y) * (acc[0][2] + bsq), bf_hi(w.y) * (acc[0][3] + bsq));
            o.z = cvt_pk_bf16(bf_lo(w.z) * (acc[1][0] + bsq), bf_hi(w.z) * (acc[1][1] + bsq)); o.w = cvt_pk_bf16(bf_lo(w.w) * (acc[1][2] + bsq), bf_hi(w.w) * (acc[1][3] + bsq));
            *(u32x4*)tp = o; }
        __syncthreads();
    }
}

constexpr int B_RAW = 0, B_POOL = 80 * 512;
__device__ __forceinline__ void p2_mixer_b(const Args& a, LAS unsigned char* lds, int bid, int tid, int wave, int lane) {
    unsigned char* ws = a.ws;
    const bf16_t* Pp = (const bf16_t*)(ws + WS_P); bf16_t* SZB = (bf16_t*)(ws + WS_SZB);
    const int gi = bid & 3, h = 1 << gi, fr = lane & 15, fq = lane >> 4;
    bf16x8 Xf[2][8];
    { const bf16_t* wp = (const bf16_t*)(ws + WS_WPT) + (size_t)gi * 65536;
#pragma unroll
      for (int n = 0; n < 2; ++n) { const int d = 32 * wave + 8 * (fr >> 2) + 4 * n + (fr & 3);
#pragma unroll
          for (int ks = 0; ks < 8; ++ks) Xf[n][ks] = *(const bf16x8*)(wp + (size_t)d * 256 + 32 * ks + 8 * fq); } }
    const int dcol = gi * 256 + 32 * wave + 8 * fq;
    f32x4 bp[2], ps[2];
    bp[0] = *(const f32x4*)(a.b_pool + dcol); bp[1] = *(const f32x4*)(a.b_pool + dcol + 4); ps[0] = *(const f32x4*)(a.pool_scale + dcol); ps[1] = *(const f32x4*)(a.pool_scale + dcol + 4);
    for (int j = 0; j < 16; ++j) {
        const int ht = (bid >> 2) + 64 * j, t0 = ht * 64;
        const int seq_len = t0 < MPROMPT ? SEQ_P : SEQ_S, seq_lo = t0 & ~(seq_len - 1), seq_hi = seq_lo + seq_len;
#pragma unroll
        for (int k = 0; k < 5; ++k) { const int idx = tid + 512 * k, r = idx >> 5, c = idx & 31, tok = t0 - 8 + r;
            u32x4 w = (u32x4){0u, 0u, 0u, 0u};
            if (tok >= seq_lo && tok < seq_hi) w = *(const u32x4*)(Pp + (size_t)tok * D + gi * 256 + 8 * c);
            *(LAS u32x4*)(lds + B_RAW + r * 512 + 16 * c) = w; }
        __syncthreads();
        { const int c16 = tid & 31, rr = tid >> 5;
          float S[8];
#pragma unroll
          for (int e = 0; e < 8; ++e) S[e] = 0.f;
          const LAS unsigned char* col = lds + B_RAW + 16 * c16;
          const int tl0 = 4 * rr;
          for (int s = -h; s < h; ++s) { const u32x4 w = *(const LAS u32x4*)(col + (8 + tl0 + s) * 512);
              S[0] += bf_lo(w.x); S[1] += bf_hi(w.x); S[2] += bf_lo(w.y); S[3] += bf_hi(w.y); S[4] += bf_lo(w.z); S[5] += bf_hi(w.z); S[6] += bf_lo(w.w); S[7] += bf_hi(w.w); }
#pragma unroll
          for (int q = 0; q < 4; ++q) { const int tl = tl0 + q, tok = t0 + tl;
              const int lo = max(tok - h, seq_lo), hi = min(tok + h, seq_hi); const float inv = 1.0f / (float)(hi - lo);
              const u32x4 w = *(const LAS u32x4*)(col + (8 + tl) * 512);
              u32x4 o; o.x = cvt_pk_bf16(S[0] * inv - bf_lo(w.x), S[1] * inv - bf_hi(w.x)); o.y = cvt_pk_bf16(S[2] * inv - bf_lo(w.y), S[3] * inv - bf_hi(w.y));
              o.z = cvt_pk_bf16(S[4] * inv - bf_lo(w.z), S[5] * inv - bf_hi(w.z)); o.w = cvt_pk_bf16(S[6] * inv - bf_lo(w.w), S[7] * inv - bf_hi(w.w));
              *(LAS u32x4*)(lds + B_POOL + tl * 528 + 16 * c16) = o;
              if (q < 3) { const u32x4 wa = *(const LAS u32x4*)(col + (8 + tl + h) * 512), wd = *(const LAS u32x4*)(col + (8 + tl - h) * 512);
                  S[0] += bf_lo(wa.x) - bf_lo(wd.x); S[1] += bf_hi(wa.x) - bf_hi(wd.x); S[2] += bf_lo(wa.y) - bf_lo(wd.y); S[3] += bf_hi(wa.y) - bf_hi(wd.y);
                  S[4] += bf_lo(wa.z) - bf_lo(wd.z); S[5] += bf_hi(wa.z) - bf_hi(wd.z); S[6] += bf_lo(wa.w) - bf_lo(wd.w); S[7] += bf_hi(wa.w) - bf_hi(wd.w); } } }
        __syncthreads();
#pragma unroll
        for (int tb = 0; tb < 4; ++tb) {
            f32x4 acc[2] = {(f32x4){0.f, 0.f, 0.f, 0.f}, (f32x4){0.f, 0.f, 0.f, 0.f}};
#pragma unroll
            for (int ks = 0; ks < 8; ++ks) { const bf16x8 Y = *(const LAS bf16x8*)(lds + B_POOL + (16 * tb + fr) * 528 + 64 * ks + 16 * fq);
                acc[0] = __builtin_amdgcn_mfma_f32_16x16x32_bf16(Xf[0][ks], Y, acc[0], 0, 0, 0); acc[1] = __builtin_amdgcn_mfma_f32_16x16x32_bf16(Xf[1][ks], Y, acc[1], 0, 0, 0); }
            bf16_t* zp = SZB + (size_t)(t0 + 16 * tb + fr) * D + dcol;
            const u32x4 w = *(const u32x4*)zp;
            const f32x4 m0 = (acc[0] + bp[0]) * ps[0], m1 = (acc[1] + bp[1]) * ps[1];
            u32x4 o; o.x = cvt_pk_bf16(m0[0] * bf_lo(w.x), m0[1] * bf_hi(w.x)); o.y = cvt_pk_bf16(m0[2] * bf_lo(w.y), m0[3] * bf_hi(w.y));
            o.z = cvt_pk_bf16(m1[0] * bf_lo(w.z), m1[1] * bf_hi(w.z)); o.w = cvt_pk_bf16(m1[2] * bf_lo(w.w), m1[3] * bf_hi(w.w));
            *(u32x4*)zp = o; }
        __syncthreads();
    }
}

__device__ __forceinline__ void p5_layernorm(const Args& a, int vcu, int G, int wave, int lane) {
    const int gw = vcu * 8 + wave, NGW = G * 8;
    f32x4 gm[4], bt[4];
#pragma unroll
    for (int j = 0; j < 4; ++j) { gm[j] = *(const f32x4*)(a.ln_g + 4 * lane + 256 * j); bt[j] = *(const f32x4*)(a.ln_b + 4 * lane + 256 * j); }
    for (int m = gw; m < MTOK; m += NGW) {
        f32x4* row = (f32x4*)(a.out + (size_t)m * D) + lane;
        f32x4 v[4]; float s = 0.f;
#pragma unroll
        for (int j = 0; j < 4; ++j) { v[j] = row[64 * j]; s += (v[j].x + v[j].y) + (v[j].z + v[j].w); }
        const float mean = wave_sum(s) * (1.f / D); float s2 = 0.f;
#pragma unroll
        for (int j = 0; j < 4; ++j) { v[j] = v[j] - mean; s2 += (v[j].x * v[j].x + v[j].y * v[j].y) + (v[j].z * v[j].z + v[j].w * v[j].w); }
        const float rstd = 1.f / sqrtf(wave_sum(s2) * (1.f / D) + LN_EPS);
#pragma unroll
        for (int j = 0; j < 4; ++j) row[64 * j] = v[j] * rstd * gm[j] + bt[j];
    }
}

__global__ void __launch_bounds__(512, 2) hybrid_fwd(Args args) {
    extern __shared__ __attribute__((aligned(16))) unsigned char lds_raw[];
    LAS unsigned char* lds = (LAS unsigned char*)lds_raw;
    volatile LAS unsigned* MISC = (volatile LAS unsigned*)(lds + MISC_OFF);
    const int tid = threadIdx.x, lane = tid & 63, wave = __builtin_amdgcn_readfirstlane(tid >> 6);
    const int G = gridDim.x, bid = blockIdx.x;
    const int vcu = (G % 8 == 0) ? (bid % 8) * (G / 8) + bid / 8 : bid;
    unsigned char* ws = args.ws;
    gu32* ctl = (gu32*)(ws + WS_CTL);
    for (int u = tid; u < (LDS_BYTES - LDSCTL_OFF) / 4; u += 512) ((LAS unsigned*)(lds + LDSCTL_OFF))[u] = 0u;
    __syncthreads();
    XcdBarrier bar; bar.bar = (unsigned*)(ctl + CW_BAR); bar.x = 0; bar.st = nullptr;
    if (MK_N_LAUNCHES == 1) bar = xcd_barrier_post((unsigned*)(ctl + CW_BAR), MISC + 8);
    const int lo = args.ph_lo, hi = args.ph_hi;
#define IN(k) (lo <= (k) && (k) < hi)
#define SEAM(k) do { if (IN(k) && IN((k) + 1)) xcd_barrier(bar); } while (0)

#ifndef SKIP0
    if (IN(0)) { p0_prologue(args, lds, vcu, G, tid, wave, lane); SEAM(0); }
#endif

#ifndef SKIP1
    if (IN(1)) {
        P1Prob P; P.XB = (const bf16_t*)(ws + WS_XB); P.WinT = (const bf16_t*)(ws + WS_WINT); P.biasp = (const float*)(ws + WS_BIASP);
        P.T = (bf16_t*)(ws + WS_T); P.V = (bf16_t*)(ws + WS_V); P.RA = (bf16_t*)(ws + WS_RA); P.GB = (bf16_t*)(ws + WS_GB);
        P.STATS = (f32x2*)(ws + WS_STATS); P.S.init(MTOK, NH, G, bid);
        pg8::gemm_phase<P1Prob, true, true>(lds, P);
        SEAM(1);
    }
#endif

#ifndef SKIP2
    if (IN(2)) {
#ifndef SKIP2A
        p2_mixer_a(args, lds, bid, tid, wave, lane);
#endif
#ifndef SKIP2B
        p2_mixer_b(args, lds, bid, tid, wave, lane);
#endif
        SEAM(2);
    }
#endif

#ifndef SKIP3
    if (IN(3)) {
        P3Prob P; P.BRA = (const bf16_t*)(ws + WS_T); P.WaT = (const bf16_t*)(ws + WS_WAT);
        P.RA = (const bf16_t*)(ws + WS_RA); P.MERGED = (bf16_t*)(ws + WS_MERGED); P.S.init(MTOK, D, G, bid);
        pg8::gemm_phase<P3Prob, true, true>(lds, P);
        SEAM(3);
    }
#endif

#ifndef SKIP4
    if (IN(4)) {
        P4Prob P; P.MERGED = (const bf16_t*)(ws + WS_MERGED); P.WoT = (const bf16_t*)(ws + WS_WOT); P.bout = args.b_out; P.xp = args.x_prompt; P.xs = args.x_sample; P.out = args.out;
        P.S.init(MTOK, D, G, bid);
        pg8::gemm_phase<P4Prob, true, true>(lds, P);
        SEAM(4);
    }
#endif

#ifndef SKIP5
    if (IN(5)) p5_layernorm(args, vcu, G, wave, lane);
#endif
#undef IN
#undef SEAM
}

extern "C" void kernel_launch(void* const* d_in, const int* in_sizes, int n_in, void* d_out, int out_size, void* d_ws, size_t ws_size, hipStream_t stream) {
    static int grid = 0;
    if (grid == 0) {
        if (n_in != 17 || in_sizes[0] != MPROMPT * D || in_sizes[1] != (MTOK - MPROMPT) * D || out_size != MTOK * D || ws_size < WS_END) {
            fprintf(stderr, "kernel_launch: unexpected shapes (n_in %d, in0 %d, in1 %d, out %d, ws %zu < %zu?)\n", n_in, n_in > 0 ? in_sizes[0] : -1, n_in > 1 ? in_sizes[1] : -1, out_size, ws_size, (size_t)WS_END); grid = -1; return; }
        int dev = 0, cus = 0, per_cu = 0;
        if (hipGetDevice(&dev) != hipSuccess || hipDeviceGetAttribute(&cus, hipDeviceAttributeMultiprocessorCount, dev) != hipSuccess) { fprintf(stderr, "kernel_launch: device query failed\n"); grid = -1; return; }
        if (hipFuncSetAttribute((const void*)hybrid_fwd, hipFuncAttributeMaxDynamicSharedMemorySize, LDS_BYTES) != hipSuccess) { fprintf(stderr, "kernel_launch: hipFuncSetAttribute failed\n"); grid = -1; return; }
        if (hipOccupancyMaxActiveBlocksPerMultiprocessor(&per_cu, (const void*)hybrid_fwd, 512, LDS_BYTES) != hipSuccess || per_cu < 1)
            fprintf(stderr, "kernel_launch: note: occupancy query reports %d workgroups per CU\n", per_cu);
        (void)hipGetLastError();
        grid = cus;
        if (grid != 256) fprintf(stderr, "kernel_launch: note: %d CUs (tuned for 256)\n", grid);
    }
    if (grid < 0) return;
    if (hipMemsetAsync((char*)d_ws + WS_CTL, 0, CTL_ZERO_BYTES, stream) != hipSuccess) { fprintf(stderr, "kernel_launch: memset failed\n"); return; }
    Args a{};
    a.x_prompt = (const float*)d_in[0]; a.x_sample = (const float*)d_in[1]; a.w_in = (const float*)d_in[2]; a.b_in = (const float*)d_in[3]; a.ln_v_g = (const float*)d_in[4]; a.ln_v_b = (const float*)d_in[5];
    a.w_spatial = (const float*)d_in[6]; a.b_spatial = (const float*)d_in[7]; a.w_pool = (const float*)d_in[8]; a.b_pool = (const float*)d_in[9]; a.pool_scale = (const float*)d_in[10];
    a.w_br_a = (const float*)d_in[11]; a.w_br_b = (const float*)d_in[12]; a.w_out = (const float*)d_in[13]; a.b_out = (const float*)d_in[14]; a.ln_g = (const float*)d_in[15]; a.ln_b = (const float*)d_in[16];
    a.out = (float*)d_out; a.ws = (unsigned char*)d_ws;
#if MK_N_LAUNCHES == 1
    a.ph_lo = 0; a.ph_hi = N_PHASES;
    hipLaunchKernelGGL(hybrid_fwd, dim3(grid), dim3(512), LDS_BYTES, stream, a);
#else
    for (int li = 0; li < N_PHASES; ++li) { a.ph_lo = li; a.ph_hi = li + 1; hipLaunchKernelGGL(hybrid_fwd, dim3(grid), dim3(512), LDS_BYTES, stream, a); }
#endif
    const hipError_t le = hipPeekAtLastError();
    if (le != hipSuccess) fprintf(stderr, "kernel_launch: launch failed: %s\n", hipGetErrorName(le));
}
```
